# Optimizing an MI355X kernel written in HIP

```python
import math
import jax, jax.numpy as jnp
from jax import lax
import numpy as np

D_MODEL = 1024
BATCH = 8
SEQ = 2048
DEPTH = 2

DIFF_HEADS = 4
DIFF_QK_DIM = 64
DIFF_V_DIM = 2 * DIFF_QK_DIM
DIFF_WIDTH = DIFF_HEADS * DIFF_V_DIM
GLA_HEADS = 4
GLA_WIDTH = D_MODEL - DIFF_WIDTH
GLA_V_DIM = GLA_WIDTH // GLA_HEADS
GLA_K_DIM = GLA_V_DIM // 2
GLA_KEY_WIDTH = GLA_HEADS * GLA_K_DIM
GLA_GATE_RANK = 16
GLA_GATE_TAU = 16.0
GLA_CHUNK = 64
D_FF = 4 * D_MODEL
N_BUCKETS = 32
MAX_DISTANCE = 128
Q_BLOCK = 128
LN_EPS = 1e-5
RMS_EPS = 1e-5
ALPHA = (2.0 * DEPTH) ** 0.25
BETA = (8.0 * DEPTH) ** -0.25
IN_SPLITS = (DIFF_WIDTH, DIFF_WIDTH, DIFF_WIDTH, GLA_KEY_WIDTH, GLA_KEY_WIDTH, GLA_WIDTH, GLA_WIDTH, GLA_GATE_RANK, GLA_GATE_RANK)
D_IN = sum(IN_SPLITS)
IN_OFFSETS = tuple(int(o) for o in np.cumsum(IN_SPLITS)[:-1])

kernel_name = "hybrid_diffattn_gla_deepnorm_encoder"


def layer_norm(x, g, b):
    xf = x.astype(jnp.float32)
    mu = jnp.mean(xf, axis=-1, keepdims=True)
    var = jnp.mean(jnp.square(xf - mu), axis=-1, keepdims=True)
    y = (xf - mu) * lax.rsqrt(var + LN_EPS)
    return (y * g.astype(jnp.float32) + b.astype(jnp.float32)).astype(x.dtype)


def rms_norm(x, w):
    xf = x.astype(jnp.float32)
    y = xf * lax.rsqrt(jnp.mean(jnp.square(xf), axis=-1, keepdims=True) + RMS_EPS)
    return (y * w.astype(jnp.float32)).astype(x.dtype)


def t5_bucket(rel):
    nb = N_BUCKETS // 2
    max_exact = nb // 2
    ret = jnp.where(rel > 0, nb, 0)
    n = jnp.abs(rel)
    large = max_exact + (jnp.log(jnp.maximum(n, 1).astype(jnp.float32) / max_exact)
                         / math.log(MAX_DISTANCE / max_exact) * (nb - max_exact)).astype(jnp.int32)
    large = jnp.minimum(large, nb - 1)
    return ret + jnp.where(n < max_exact, n, large)


def diff_attention(q1, q2, k1, k2, v, lam, table):
    B, H, S, dq = q1.shape
    dv = v.shape[-1]
    nb = S // Q_BLOCK

    def blocks(t):
        return t.reshape(B, H, nb, Q_BLOCK, dq).transpose(2, 0, 1, 3, 4)

    kpos = jnp.arange(S, dtype=jnp.int32)
    lam32 = lam.astype(jnp.float32)

    def one_block(args):
        q1b, q2b, start = args
        qpos = start + jnp.arange(Q_BLOCK, dtype=jnp.int32)
        bias = table[t5_bucket(kpos[None, :] - qpos[:, None])]
        bias = jnp.transpose(bias, (2, 0, 1))[None].astype(jnp.float32)
        s1 = jnp.einsum('bhqd,bhkd->bhqk', q1b, k1).astype(jnp.float32) + bias
        s2 = jnp.einsum('bhqd,bhkd->bhqk', q2b, k2).astype(jnp.float32) + bias
        a = (jax.nn.softmax(s1, axis=-1) - lam32 * jax.nn.softmax(s2, axis=-1)).astype(v.dtype)
        return jnp.einsum('bhqk,bhkd->bhqd', a, v)

    starts = jnp.arange(nb, dtype=jnp.int32) * Q_BLOCK
    out = lax.map(one_block, (blocks(q1), blocks(q2), starts))
    return out.transpose(1, 2, 0, 3, 4).reshape(B, H, S, dv)


def gla_direction(q, k, v, g, strict):
    B, H, S, dk = q.shape
    dv = v.shape[-1]
    C = GLA_CHUNK
    nc = S // C
    f32 = jnp.float32
    qc = q.astype(f32).reshape(B, H, nc, C, dk)
    kc = k.astype(f32).reshape(B, H, nc, C, dk)
    vc = v.astype(f32).reshape(B, H, nc, C, dv)
    b = jnp.cumsum(g.astype(f32).reshape(B, H, nc, C, dk), axis=3)
    b_last = b[..., -1:, :]
    q_t = qc * jnp.exp(b)
    k_t = kc * jnp.exp(-b)
    k_d = kc * jnp.exp(b_last - b)
    dec = jnp.exp(b_last[..., 0, :])
    mask = jnp.tril(jnp.ones((C, C), dtype=bool), k=-1 if strict else 0)
    scores = jnp.where(mask, jnp.einsum('bhncd,bhnsd->bhncs', q_t, k_t), 0.0)
    o_intra = jnp.einsum('bhncs,bhnse->bhnce', scores, vc)

    def step(state, inp):
        qn, kn, vn, dn = inp
        o = jnp.einsum('bhcd,bhde->bhce', qn, state)
        state = dn[..., None] * state + jnp.einsum('bhcd,bhce->bhde', kn, vn)
        return state, o

    xs = (jnp.moveaxis(q_t, 2, 0), jnp.moveaxis(k_d, 2, 0), jnp.moveaxis(vc, 2, 0), jnp.moveaxis(dec, 2, 0))
    _, o_inter = lax.scan(step, jnp.zeros((B, H, dk, dv), f32), xs)
    o = o_intra + jnp.moveaxis(o_inter, 0, 2)
    return o.reshape(B, H, S, dv)


def hybrid_layer(x, li, table, w_in, lq1, lk1, lq2, lk2, diff_norm_w, gate_up, gate_b,
                 gla_norm_w, w_o, ln1_g, ln1_b, w1, b1, w2, b2, ln2_g, ln2_b):
    B, S, _ = x.shape
    h = x @ w_in
    dq, dk_, dv_, gq, gk, gv, gr, gdf, gdb = jnp.split(h, IN_OFFSETS, axis=-1)

    dq = dq.reshape(B, S, DIFF_HEADS, 2, DIFF_QK_DIM) * (DIFF_QK_DIM ** -0.5)
    dk_ = dk_.reshape(B, S, DIFF_HEADS, 2, DIFF_QK_DIM)
    q1 = dq[..., 0, :].transpose(0, 2, 1, 3)
    q2 = dq[..., 1, :].transpose(0, 2, 1, 3)
    k1 = dk_[..., 0, :].transpose(0, 2, 1, 3)
    k2 = dk_[..., 1, :].transpose(0, 2, 1, 3)
    vd = dv_.reshape(B, S, DIFF_HEADS, DIFF_V_DIM).transpose(0, 2, 1, 3)
    lam_init = 0.8 - 0.6 * math.exp(-0.3 * li)
    lam = (jnp.exp(jnp.sum(lq1.astype(jnp.float32) * lk1.astype(jnp.float32)))
           - jnp.exp(jnp.sum(lq2.astype(jnp.float32) * lk2.astype(jnp.float32))) + lam_init)
    d_out = diff_attention(q1, q2, k1, k2, vd, lam, table)
    d_out = rms_norm(d_out, diff_norm_w) * (1.0 - lam_init)
    d_out = d_out.transpose(0, 2, 1, 3).reshape(B, S, DIFF_WIDTH)

    def heads(t, d):
        return t.reshape(B, S, GLA_HEADS, d).transpose(0, 2, 1, 3)
    gq = heads(gq, GLA_K_DIM) * (GLA_K_DIM ** -0.5)
    gk = heads(gk, GLA_K_DIM)
    gv = heads(gv, GLA_V_DIM)
    g_f = heads(jax.nn.log_sigmoid((gdf @ gate_up[0] + gate_b[0]).astype(jnp.float32)) / GLA_GATE_TAU, GLA_K_DIM)
    g_b = heads(jax.nn.log_sigmoid((gdb @ gate_up[1] + gate_b[1]).astype(jnp.float32)) / GLA_GATE_TAU, GLA_K_DIM)
    o_f = gla_direction(gq, gk, gv, g_f, False)
    flip = lambda t: jnp.flip(t, axis=2)
    o_b = flip(gla_direction(flip(gq), flip(gk), flip(gv), flip(g_b), True))
    g_out = rms_norm((o_f + o_b).astype(x.dtype), gla_norm_w)
    g_out = g_out.transpose(0, 2, 1, 3).reshape(B, S, GLA_WIDTH) * jax.nn.silu(gr)

    mix = jnp.concatenate([d_out, g_out], axis=-1) @ w_o
    x = layer_norm(ALPHA * x + mix, ln1_g, ln1_b)

    f = jnp.square(jax.nn.relu(x @ w1 + b1)) @ w2 + b2
    return layer_norm(ALPHA * x + f, ln2_g, ln2_b)


def setup_inputs(seed: int = 0) -> dict:
    key = jax.random.key(seed)
    ks = jax.random.split(key, 24)
    n = lambda k, shape, s: jax.random.normal(k, shape, jnp.float32) * s
    return {
        "x": n(ks[0], (BATCH, SEQ, D_MODEL), 1.0),
        "ln_emb_g": 1.0 + n(ks[1], (D_MODEL,), 0.02),
        "ln_emb_b": n(ks[2], (D_MODEL,), 0.02),
        "rel_bias_table": n(ks[3], (N_BUCKETS, DIFF_HEADS), 0.3),
        "w_in": n(ks[4], (DEPTH, D_MODEL, D_IN), D_MODEL ** -0.5),
        "lambda_q1": n(ks[5], (DEPTH, DIFF_QK_DIM), 0.1),
        "lambda_k1": n(ks[6], (DEPTH, DIFF_QK_DIM), 0.1),
        "lambda_q2": n(ks[7], (DEPTH, DIFF_QK_DIM), 0.1),
        "lambda_k2": n(ks[8], (DEPTH, DIFF_QK_DIM), 0.1),
        "diff_norm_w": 1.0 + n(ks[9], (DEPTH, DIFF_V_DIM), 0.02),
        "gla_gate_up": n(ks[10], (DEPTH, 2, GLA_GATE_RANK, GLA_KEY_WIDTH), GLA_GATE_RANK ** -0.5),
        "gla_gate_bias": n(ks[11], (DEPTH, 2, GLA_KEY_WIDTH), 0.1),
        "gla_norm_w": 1.0 + n(ks[12], (DEPTH, GLA_V_DIM), 0.02),
        "w_o": n(ks[13], (DEPTH, D_MODEL, D_MODEL), BETA * D_MODEL ** -0.5),
        "ln1_g": 1.0 + n(ks[14], (DEPTH, D_MODEL), 0.02),
        "ln1_b": n(ks[15], (DEPTH, D_MODEL), 0.02),
        "w_ffn1": n(ks[16], (DEPTH, D_MODEL, D_FF), D_MODEL ** -0.5),
        "b_ffn1": n(ks[17], (DEPTH, D_FF), 0.02),
        "w_ffn2": n(ks[18], (DEPTH, D_FF, D_MODEL), BETA * D_FF ** -0.5),
        "b_ffn2": n(ks[19], (DEPTH, D_MODEL), 0.02),
        "ln2_g": 1.0 + n(ks[20], (DEPTH, D_MODEL), 0.02),
        "ln2_b": n(ks[21], (DEPTH, D_MODEL), 0.02),
    }


def reference(x, ln_emb_g, ln_emb_b, rel_bias_table, w_in, lambda_q1, lambda_k1, lambda_q2, lambda_k2,
              diff_norm_w, gla_gate_up, gla_gate_bias, gla_norm_w, w_o, ln1_g, ln1_b,
              w_ffn1, b_ffn1, w_ffn2, b_ffn2, ln2_g, ln2_b):
    h = layer_norm(x, ln_emb_g, ln_emb_b)
    for li in range(DEPTH):
        h = hybrid_layer(h, li, rel_bias_table, w_in[li], lambda_q1[li], lambda_k1[li],
                         lambda_q2[li], lambda_k2[li], diff_norm_w[li], gla_gate_up[li],
                         gla_gate_bias[li], gla_norm_w[li], w_o[li], ln1_g[li], ln1_b[li],
                         w_ffn1[li], b_ffn1[li], w_ffn2[li], b_ffn2[li], ln2_g[li], ln2_b[li])
    return h
```

```cpp
#include <hip/hip_runtime.h>
#include <cstdio>
#include <cstdint>
#include <cmath>

constexpr int BATCH = 8, SEQ = 2048, D = 1024, DEPTH = 2;
constexpr int T = BATCH * SEQ;
constexpr int DH = 4, DQK = 64, DV = 128, DW = 512;
constexpr int GH = 4, GK = 64, GV_ = 128, GKW = 256, GW = 512, RANK = 16, CH = 64;
constexpr int FF = 4096, D_IN = 3104, N_MAIN = 3072;
constexpr float LN_EPS = 1e-5f, RMS_EPS = 1e-5f;
constexpr float ALPHA = 1.4142135623730951f;
constexpr float LOG2E = 1.4426950408889634f;
constexpr float C2 = 0.125f * LOG2E;

typedef unsigned short bf16;
__device__ __forceinline__ unsigned f2bf(float f) { unsigned u = __builtin_bit_cast(unsigned, f); return (u + 0x7fffu + ((u >> 16) & 1u)) >> 16; }
__device__ __forceinline__ float bf2f(bf16 b) { return __builtin_bit_cast(float, (unsigned)b << 16); }

constexpr size_t MiB = 1u << 20;
constexpr size_t WS_CTL = 0, WS_XBUF = 1 * MiB;
constexpr size_t WS_W = 4 * MiB, W_LAYER = 25 * MiB, W_IN = 0, W_O = 6 * MiB + 512 * 1024, W_1 = 8 * MiB + 512 * 1024, W_2 = 16 * MiB + 512 * 1024;
constexpr size_t WS_XN = 54 * MiB, WS_ST = WS_XN;
constexpr size_t WS_CC = 86 * MiB;
constexpr size_t WS_BIG = 118 * MiB;
constexpr size_t WS_DQ = WS_BIG, WS_DK = WS_BIG + 16 * MiB, WS_DV = WS_BIG + 32 * MiB, WS_GQK = WS_BIG + 48 * MiB, WS_GV = WS_BIG + 64 * MiB, WS_GR = WS_BIG + 80 * MiB;
constexpr size_t WS_BF = WS_BIG + 96 * MiB, WS_BB = WS_BIG + 112 * MiB;
constexpr size_t WS_H = WS_BIG;
constexpr size_t WS_GD = 246 * MiB;
constexpr size_t WS_OF = WS_DQ, WS_OB = WS_BF;
constexpr size_t WS_END = 248 * MiB;

struct LayerW { const float *w_in, *lq1, *lk1, *lq2, *lk2, *dnw, *gup, *gb, *gnw, *w_o, *ln1g, *ln1b, *w1, *b1, *w2, *b2, *ln2g, *ln2b; };

__device__ __forceinline__ float block_sum256(float v, float* red) {
    for (int o = 32; o > 0; o >>= 1) v += __shfl_xor(v, o);
    __syncthreads(); if ((threadIdx.x & 63) == 0) red[threadIdx.x >> 6] = v; __syncthreads();
    return red[0] + red[1] + red[2] + red[3];
}
__device__ __forceinline__ void ln_row_store(float (&v)[4], const float* g, const float* b, float* xrow, bf16* xnrow, float* red) {
    float s = v[0] + v[1] + v[2] + v[3]; const float mean = block_sum256(s, red) * (1.f / D);
    float q = 0.f;
#pragma unroll
    for (int j = 0; j < 4; ++j) { v[j] -= mean; q += v[j] * v[j]; }
    const float rstd = 1.f / sqrtf(block_sum256(q, red) * (1.f / D) + LN_EPS);
#pragma unroll
    for (int j = 0; j < 4; ++j) { const int c = threadIdx.x + 256 * j; const float o = v[j] * rstd * g[c] + b[c]; xrow[c] = o; xnrow[c] = (bf16)f2bf(o); }
}
__global__ void __launch_bounds__(256) n_ln_emb(const float* x, const float* g, const float* b, float* X, bf16* XN) {
    __shared__ float red[4]; const int t = blockIdx.x; float v[4];
#pragma unroll
    for (int j = 0; j < 4; ++j) v[j] = x[(size_t)t * D + threadIdx.x + 256 * j];
    ln_row_store(v, g, b, X + (size_t)t * D, XN + (size_t)t * D, red);
}
template <int MODE> __global__ void __launch_bounds__(256) n_gemm(const bf16* A, const float* W, int K, int N, const float* bias, unsigned char* ws) {
    const int r0 = blockIdx.x * 8, c = blockIdx.y * 256 + threadIdx.x; if (c >= N) return;
    float acc[8] = {0, 0, 0, 0, 0, 0, 0, 0};
    for (int k = 0; k < K; ++k) { const float w = W[(size_t)k * N + c];
#pragma unroll
        for (int r = 0; r < 8; ++r) acc[r] += bf2f(A[(size_t)(r0 + r) * K + k]) * w; }
#pragma unroll
    for (int r = 0; r < 8; ++r) { const size_t t = r0 + r; float v = acc[r];
        if (MODE == 0) {
            if (c < 512) ((bf16*)(ws + WS_DQ))[t * 512 + c] = (bf16)f2bf(v * C2);
            else if (c < 1024) ((bf16*)(ws + WS_DK))[t * 512 + c - 512] = (bf16)f2bf(v);
            else if (c < 1536) ((bf16*)(ws + WS_DV))[t * 512 + c - 1024] = (bf16)f2bf(v);
            else if (c < 1792) ((bf16*)(ws + WS_GQK))[t * 512 + c - 1536] = (bf16)f2bf(v * 0.125f);
            else if (c < 2048) ((bf16*)(ws + WS_GQK))[t * 512 + c - 1536] = (bf16)f2bf(v);
            else if (c < 2560) ((bf16*)(ws + WS_GV))[t * 512 + c - 2048] = (bf16)f2bf(v);
            else if (c < 3072) ((bf16*)(ws + WS_GR))[t * 512 + c - 2560] = (bf16)f2bf(v);
            else ((float*)(ws + WS_GD))[t * 32 + c - 3072] = v;
        } else if (MODE == 1) {
            v += bias[c]; v = v > 0.f ? v * v : 0.f; ((bf16*)(ws + WS_H))[t * FF + c] = (bf16)f2bf(v);
        }
    }
}
__global__ void __launch_bounds__(256) n_gemm_ln(const bf16* A, const float* W, int K, const float* bias, const float* g, const float* b, float* X, bf16* XN) {
    __shared__ float red[4]; const int r0 = blockIdx.x * 8;
    float acc[8][4];
#pragma unroll
    for (int r = 0; r < 8; ++r)
#pragma unroll
        for (int j = 0; j < 4; ++j) acc[r][j] = 0.f;
    for (int k = 0; k < K; ++k) { float w[4];
#pragma unroll
        for (int j = 0; j < 4; ++j) w[j] = W[(size_t)k * D + threadIdx.x + 256 * j];
#pragma unroll
        for (int r = 0; r < 8; ++r) { const float a = bf2f(A[(size_t)(r0 + r) * K + k]);
#pragma unroll
            for (int j = 0; j < 4; ++j) acc[r][j] += a * w[j]; } }
#pragma unroll
    for (int r = 0; r < 8; ++r) { const size_t t = r0 + r; float v[4];
#pragma unroll
        for (int j = 0; j < 4; ++j) { const int c = threadIdx.x + 256 * j; v[j] = ALPHA * X[t * D + c] + acc[r][j] + (bias ? bias[c] : 0.f); }
        ln_row_store(v, g, b, X + t * D, XN + t * D, red); }
}
__global__ void __launch_bounds__(256) n_gates(const float* GD, const float* gup, const float* gb, float* BF, float* BB) {
    const int chunk = blockIdx.x, c = blockIdx.y * 256 + threadIdx.x, dir = c >> 8, col = c & 255;
    float up[16];
#pragma unroll
    for (int j = 0; j < 16; ++j) up[j] = gup[(size_t)(dir * 16 + j) * 256 + col];
    const float bias = gb[dir * 256 + col]; float run = 0.f;
    for (int i = 0; i < 64; ++i) { const int tok = dir == 0 ? i : 63 - i; const size_t t = (size_t)chunk * 64 + tok;
        float z = bias;
#pragma unroll
        for (int j = 0; j < 16; ++j) z += GD[t * 32 + dir * 16 + j] * up[j];
        const float g = (fminf(z, 0.f) - log1pf(expf(-fabsf(z)))) * (1.f / 16.f);
        run += g; (dir == 0 ? BF : BB)[t * 256 + col] = run; }
}
__device__ __forceinline__ int t5_bucket(int rel) {
    const int n = rel < 0 ? -rel : rel; int b;
    if (n < 8) b = n; else if (n < 12) b = 8; else if (n < 16) b = 9; else if (n < 23) b = 10; else if (n < 32) b = 11; else if (n < 46) b = 12; else if (n < 64) b = 13; else if (n < 91) b = 14; else b = 15;
    return b + (rel > 0 ? 16 : 0);
}
__device__ __forceinline__ float lam_of(const float* lq1, const float* lk1, const float* lq2, const float* lk2, float lam_init) {
    float s1 = 0.f, s2 = 0.f; for (int i = 0; i < 64; ++i) { s1 += lq1[i] * lk1[i]; s2 += lq2[i] * lk2[i]; }
    return expf(s1) - expf(s2) + lam_init;
}
__global__ void __launch_bounds__(128) n_attn(const bf16* DQ, const bf16* DK, const bf16* DVb, const float* table, LayerW L, float lam_init, bf16* CC) {
    __shared__ float qs[128]; __shared__ float a[SEQ]; __shared__ float a2[SEQ]; __shared__ float red[4];
    const int q = blockIdx.x % SEQ, h = (blockIdx.x / SEQ) % DH, b = blockIdx.x / (SEQ * DH), tid = threadIdx.x;
    const size_t trow = (size_t)b * SEQ + q;
    qs[tid] = bf2f(DQ[trow * 512 + h * 128 + tid]); __syncthreads();
    float m1 = -1e30f, m2 = -1e30f;
    for (int k = tid; k < SEQ; k += 128) { const bf16* kr = DK + ((size_t)b * SEQ + k) * 512 + h * 128; float s1 = 0.f, s2 = 0.f;
        for (int d = 0; d < 64; ++d) { s1 += qs[d] * bf2f(kr[d]); s2 += qs[64 + d] * bf2f(kr[64 + d]); }
        const float bias = table[t5_bucket(k - q) * DH + h] * LOG2E; s1 += bias; s2 += bias; a[k] = s1; a2[k] = s2; m1 = fmaxf(m1, s1); m2 = fmaxf(m2, s2); }
    auto bmax = [&](float v) { for (int o = 32; o > 0; o >>= 1) v = fmaxf(v, __shfl_xor(v, o)); __syncthreads(); if ((tid & 63) == 0) red[tid >> 6] = v; __syncthreads(); return fmaxf(red[0], red[1]); };
    auto bsum = [&](float v) { for (int o = 32; o > 0; o >>= 1) v += __shfl_xor(v, o); __syncthreads(); if ((tid & 63) == 0) red[tid >> 6] = v; __syncthreads(); return red[0] + red[1]; };
    m1 = bmax(m1); m2 = bmax(m2); float l1 = 0.f, l2 = 0.f;
    for (int k = tid; k < SEQ; k += 128) { const float p1 = exp2f(a[k] - m1), p2 = exp2f(a2[k] - m2); a[k] = p1; a2[k] = p2; l1 += p1; l2 += p2; }
    l1 = bsum(l1); l2 = bsum(l2);
    const float lam = lam_of(L.lq1, L.lk1, L.lq2, L.lk2, lam_init), i1 = 1.f / l1, i2 = lam / l2;
    float o = 0.f;
    for (int k = 0; k < SEQ; ++k) o += (a[k] * i1 - a2[k] * i2) * bf2f(DVb[((size_t)b * SEQ + k) * 512 + h * 128 + tid]);
    const float ss = bsum(o * o); const float r = 1.f / sqrtf(ss * (1.f / 128.f) + RMS_EPS);
    CC[trow * D + h * 128 + tid] = (bf16)f2bf(o * r * L.dnw[tid] * (1.f - lam_init));
}
__global__ void __launch_bounds__(128) n_gla(const bf16* GQK, const bf16* GVb, const float* GD, const float* gup, const float* gb, float* OF, float* OB) {
    __shared__ float sq[64], sk[64], sa[64];
    const int dir = blockIdx.x & 1, h = (blockIdx.x >> 1) & 3, b = blockIdx.x >> 3, j = threadIdx.x;
    float S[64];
#pragma unroll
    for (int i = 0; i < 64; ++i) S[i] = 0.f;
    for (int step = 0; step < SEQ; ++step) { const int tok = dir == 0 ? step : SEQ - 1 - step; const size_t t = (size_t)b * SEQ + tok;
        __syncthreads();
        if (j < 64) { sq[j] = bf2f(GQK[t * 512 + h * 64 + j]); sk[j] = bf2f(GQK[t * 512 + 256 + h * 64 + j]);
            const int col = h * 64 + j; float z = gb[dir * 256 + col]; for (int r = 0; r < 16; ++r) z += GD[t * 32 + dir * 16 + r] * gup[(size_t)(dir * 16 + r) * 256 + col];
            sa[j] = expf((fminf(z, 0.f) - log1pf(expf(-fabsf(z)))) * (1.f / 16.f)); }
        __syncthreads();
        const float v = bf2f(GVb[t * 512 + h * 128 + j]); float o = 0.f;
        if (dir == 0) {
#pragma unroll
            for (int i = 0; i < 64; ++i) { S[i] = sa[i] * S[i] + sk[i] * v; o += sq[i] * S[i]; }
            OF[t * 512 + h * 128 + j] = o; }
        else {
#pragma unroll
            for (int i = 0; i < 64; ++i) { const float d = sa[i] * S[i]; o += sq[i] * d; S[i] = d + sk[i] * v; }
            OB[t * 512 + h * 128 + j] = o; }
    }
}
__global__ void __launch_bounds__(128) n_gla_out(const float* OF, const float* OB, const bf16* GR, const float* gnw, bf16* CC) {
    __shared__ float red[4]; const int h = blockIdx.x & 3, j = threadIdx.x; const size_t t = blockIdx.x >> 2;
    const float o = OF[t * 512 + h * 128 + j] + OB[t * 512 + h * 128 + j]; float v = o * o;
    for (int s = 32; s > 0; s >>= 1) v += __shfl_xor(v, s); if ((j & 63) == 0) red[j >> 6] = v; __syncthreads();
    const float r = 1.f / sqrtf((red[0] + red[1]) * (1.f / 128.f) + RMS_EPS); const float gr = bf2f(GR[t * 512 + h * 128 + j]);
    CC[t * D + 512 + h * 128 + j] = (bf16)f2bf(o * r * gnw[j] * (gr / (1.f + expf(-gr))));
}

extern "C" void kernel_launch(void* const* d_in, const int* in_sizes, int n_in, void* d_out, int out_size, void* d_ws, size_t ws_size, hipStream_t stream) {
    if (n_in != 22 || in_sizes[0] != T * D || out_size != T * D || ws_size < WS_END) { fprintf(stderr, "kernel_launch: unexpected shapes (n_in %d, in0 %d, out %d, ws %zu)\n", n_in, n_in > 0 ? in_sizes[0] : -1, out_size, ws_size); return; }
    unsigned char* ws = (unsigned char*)d_ws; float* X = (float*)d_out;
    auto F = [&](int i) { return (const float*)d_in[i]; };
    bf16* XN = (bf16*)(ws + WS_XN); bf16* CC = (bf16*)(ws + WS_CC);
    hipLaunchKernelGGL(n_ln_emb, dim3(T), dim3(256), 0, stream, F(0), F(1), F(2), X, XN);
    for (int li = 0; li < DEPTH; ++li) {
        LayerW L; L.w_in = F(4) + (size_t)li * D * D_IN; L.lq1 = F(5) + li * 64; L.lk1 = F(6) + li * 64; L.lq2 = F(7) + li * 64; L.lk2 = F(8) + li * 64; L.dnw = F(9) + li * 128;
        L.gup = F(10) + (size_t)li * 2 * 16 * 256; L.gb = F(11) + li * 512; L.gnw = F(12) + li * 128; L.w_o = F(13) + (size_t)li * D * D; L.ln1g = F(14) + li * D; L.ln1b = F(15) + li * D;
        L.w1 = F(16) + (size_t)li * D * FF; L.b1 = F(17) + li * FF; L.w2 = F(18) + (size_t)li * FF * D; L.b2 = F(19) + li * D; L.ln2g = F(20) + li * D; L.ln2b = F(21) + li * D;
        const float lam_init = 0.8f - 0.6f * expf(-0.3f * (float)li);
        hipLaunchKernelGGL(n_gemm<0>, dim3(T / 8, (D_IN + 255) / 256), dim3(256), 0, stream, XN, L.w_in, D, D_IN, (const float*)nullptr, ws);
        hipLaunchKernelGGL(n_attn, dim3(BATCH * DH * SEQ), dim3(128), 0, stream, (const bf16*)(ws + WS_DQ), (const bf16*)(ws + WS_DK), (const bf16*)(ws + WS_DV), F(3), L, lam_init, CC);
        hipLaunchKernelGGL(n_gla, dim3(BATCH * GH * 2), dim3(128), 0, stream, (const bf16*)(ws + WS_GQK), (const bf16*)(ws + WS_GV), (const float*)(ws + WS_GD), L.gup, L.gb, (float*)(ws + WS_OF), (float*)(ws + WS_OB));
        hipLaunchKernelGGL(n_gla_out, dim3(T * 4), dim3(128), 0, stream, (const float*)(ws + WS_OF), (const float*)(ws + WS_OB), (const bf16*)(ws + WS_GR), L.gnw, CC);
        hipLaunchKernelGGL(n_gemm_ln, dim3(T / 8), dim3(256), 0, stream, CC, L.w_o, D, (const float*)nullptr, L.ln1g, L.ln1b, X, XN);
        hipLaunchKernelGGL(n_gemm<1>, dim3(T / 8, FF / 256), dim3(256), 0, stream, XN, L.w1, D, FF, L.b1, ws);
        hipLaunchKernelGGL(n_gemm_ln, dim3(T / 8), dim3(256), 0, stream, (const bf16*)(ws + WS_H), L.w2, FF, L.b2, L.ln2g, L.ln2b, X, XN);
    }
}
```
